# Optimizing an MI355X kernel written in HIP

```python
import jax, jax.numpy as jnp
from jax import lax
import numpy as np

D_MODEL = 1024
BATCH = 16
SEQ = 2048
DEPTH = 1

PLE_DIM = 256
CONV_WIDTH = D_MODEL // 2
CONV_GROUPS = 8
CONV_K = 3
RET_HEADS = 4
RET_HEAD_DIM = 128
RET_WIDTH = RET_HEADS * RET_HEAD_DIM
MIX_WIDTH = CONV_WIDTH + RET_WIDTH
IN_COLS = 3 * CONV_WIDTH + 4 * RET_WIDTH
D_FF = -(-8 * D_MODEL // (3 * 256)) * 256
CHUNK = 128
ROPE_BASE = 10000.0
EPS = 1e-6

kernel_name = "hybrid_shortconv_retention_block"


def rmsnorm(x, g):
    xf = x.astype(jnp.float32)
    y = xf * lax.rsqrt(jnp.mean(xf * xf, axis=-1, keepdims=True) + EPS)
    return (y * g.astype(jnp.float32)).astype(x.dtype)


def head_groupnorm(y, g):
    mu = jnp.mean(y, axis=-1, keepdims=True)
    var = jnp.mean(jnp.square(y - mu), axis=-1, keepdims=True)
    yn = (y - mu) * lax.rsqrt(var + EPS)
    b, s, h, d = y.shape
    return yn.reshape(b, s, h * d) * g.astype(jnp.float32)


def rope(x, pos):
    half = x.shape[-1] // 2
    inv_freq = ROPE_BASE ** (-jnp.arange(half, dtype=jnp.float32) / half)
    ang = pos[:, None] * inv_freq[None, :]
    cos = jnp.cos(ang)[None, :, None, :]
    sin = jnp.sin(ang)[None, :, None, :]
    x1, x2 = x[..., :half], x[..., half:]
    return jnp.concatenate([x1 * cos - x2 * sin, x2 * cos + x1 * sin], axis=-1)


def retention_chunkwise(q, k, v):
    b, s, h, d = q.shape
    n = s // CHUNK
    log_gamma = jnp.log(1.0 - jnp.power(2.0, -5.0 - jnp.arange(h, dtype=jnp.float32)))

    def to_chunks(t):
        return t.reshape(b, n, CHUNK, h, d).transpose(0, 3, 1, 2, 4)

    qc, kc, vc = to_chunks(q), to_chunks(k), to_chunks(v)
    idx = jnp.arange(CHUNK, dtype=jnp.float32)
    diff = idx[:, None] - idx[None, :]
    decay_mask = jnp.where(diff[None] >= 0,
                           jnp.exp(log_gamma[:, None, None] * jnp.maximum(diff, 0.0)[None]),
                           0.0)

    scores = jnp.einsum('bhncd,bhnmd->bhncm', qc, kc) * decay_mask[None, :, None]
    intra = jnp.einsum('bhncm,bhnme->bhnce', scores, vc)

    k_decay = jnp.exp(log_gamma[:, None] * (CHUNK - 1 - idx)[None])
    kv = jnp.einsum('bhncd,hc,bhnce->bhnde', kc, k_decay, vc)
    chunk_decay = jnp.exp(log_gamma * CHUNK)[None, :, None, None]

    def step(state, kv_c):
        return state * chunk_decay + kv_c, state

    init = jnp.zeros((b, h, d, d), jnp.float32)
    _, states_in = lax.scan(step, init, jnp.moveaxis(kv, 2, 0))
    states_in = jnp.moveaxis(states_in, 0, 2)

    q_decay = jnp.exp(log_gamma[:, None] * (idx + 1.0)[None])
    cross = jnp.einsum('bhncd,hc,bhnde->bhnce', qc, q_decay, states_in)

    out = intra + cross
    return out.transpose(0, 2, 3, 1, 4).reshape(b, s, h, d)


def setup_inputs(seed: int = 0) -> dict:
    key = jax.random.key(seed)
    ks = jax.random.split(key, 16)
    f32 = jnp.float32

    def w(k, shape, fan_in):
        return jax.random.normal(k, shape, f32) * (fan_in ** -0.5)

    def gain(k, shape):
        return 1.0 + 0.02 * jax.random.normal(k, shape, f32)

    return {
        "x": jax.random.normal(ks[0], (BATCH, SEQ, D_MODEL), f32),
        "p": jax.random.normal(ks[1], (DEPTH, BATCH, SEQ, PLE_DIM), f32),
        "g_mix": gain(ks[2], (DEPTH, D_MODEL)),
        "w_in": w(ks[3], (DEPTH, D_MODEL, IN_COLS), D_MODEL),
        "conv_w": w(ks[4], (DEPTH, CONV_K, CONV_WIDTH), CONV_K),
        "ret_gn": gain(ks[5], (DEPTH, RET_WIDTH)),
        "w_out": w(ks[6], (DEPTH, MIX_WIDTH, D_MODEL), MIX_WIDTH),
        "g_ffn": gain(ks[7], (DEPTH, D_MODEL)),
        "w_gate": w(ks[8], (DEPTH, D_MODEL, D_FF), D_MODEL),
        "w_up": w(ks[9], (DEPTH, D_MODEL, D_FF), D_MODEL),
        "w_down": w(ks[10], (DEPTH, D_FF, D_MODEL), D_FF),
        "g_ple": gain(ks[11], (DEPTH, D_MODEL)),
        "w_ple_gate": w(ks[12], (DEPTH, D_MODEL, D_MODEL), D_MODEL),
        "w_ple_proj": w(ks[13], (DEPTH, PLE_DIM, D_MODEL), PLE_DIM),
        "g_final": gain(ks[14], (D_MODEL,)),
    }


def reference(x, p, g_mix, w_in, conv_w, ret_gn, w_out, g_ffn, w_gate, w_up,
              w_down, g_ple, w_ple_gate, w_ple_proj, g_final):
    b, s, _ = x.shape
    pos = jnp.arange(s, dtype=jnp.float32)
    splits = np.cumsum([CONV_WIDTH] * 3 + [RET_WIDTH] * 3).tolist()
    h = x
    for i in range(DEPTH):
        u = rmsnorm(h, g_mix[i])
        proj = u @ w_in[i]
        cb, cc, cx, rq, rk, rv, rg = jnp.split(proj, splits, axis=-1)

        z = cc * cx
        z_pad = jnp.pad(z, ((0, 0), (CONV_K - 1, 0), (0, 0)))
        conv = sum(conv_w[i][j] * z_pad[:, j:j + s] for j in range(CONV_K))
        y_conv = cb * conv

        q = rope(rq.reshape(b, s, RET_HEADS, RET_HEAD_DIM).astype(jnp.float32), pos)
        k = rope(rk.reshape(b, s, RET_HEADS, RET_HEAD_DIM).astype(jnp.float32), pos)
        k = k * (RET_HEAD_DIM ** -0.5)
        v = rv.reshape(b, s, RET_HEADS, RET_HEAD_DIM).astype(jnp.float32)
        y_ret = head_groupnorm(retention_chunkwise(q, k, v), ret_gn[i])
        y_ret = (jax.nn.silu(rg.astype(jnp.float32)) * y_ret).astype(x.dtype)

        h = h + jnp.concatenate([y_conv, y_ret], axis=-1) @ w_out[i]

        u = rmsnorm(h, g_ffn[i])
        h = h + (jax.nn.silu(u @ w_gate[i]) * (u @ w_up[i])) @ w_down[i]

        u = rmsnorm(h, g_ple[i])
        h = h + jax.nn.sigmoid(u @ w_ple_gate[i]) * (p[i] @ w_ple_proj[i])
    return rmsnorm(h, g_final)
```

```cpp
#include <hip/hip_runtime.h>
#include <hip/hip_cooperative_groups.h>
#include <cstdio>
#include <cstdint>
namespace pg8 {
#define PG8_LAS __attribute__((address_space(3)))
typedef unsigned short bf16_t;
typedef short bf16x8 __attribute__((ext_vector_type(8)));
typedef float f32x4 __attribute__((ext_vector_type(4)));
typedef unsigned u32x4 __attribute__((ext_vector_type(4)));
constexpr int BM = 256, BK = 64, HALF = 128, HTB = HALF * BK * 2  , STAGE_BYTES = 8 * HTB, NXCD = 8, WGM = 8;

__host__ __device__ __forceinline__ int lds_byte(int r, int c) { const int st = (r >> 4) * 2 + (c >> 5), rr = r & 15, cc = c & 31, ob = rr * 64 + cc * 2; return st * 1024 + (ob ^ (((ob >> 9) & 1) << 5)); }
__host__ __device__ __forceinline__ void stage_rc(int b, int& R, int& C) { const int st = b / 1024, sb = b % 1024, swz = sb ^ (((sb >> 9) & 1) << 5); R = (st >> 1) * 16 + swz / 64; C = (st & 1) * 32 + (swz % 64) / 2; }
__host__ __device__ __forceinline__ int perm32(int rho) { const int n = rho >> 4, i = rho & 15; return 8 * (i >> 2) + 4 * n + (i & 3); }

struct Unit { int pm, pn; };
struct Gemm { const bf16_t* A; const bf16_t* Bt; int M, N, K; };

struct StaticOrder {
    int nM, nN, nwg, G, c;
    __host__ __device__ void init(int M, int N, int G_, int c_) { nM = M / BM; nN = N / BM; nwg = nM * nN; G = G_; c = c_; }
    __host__ __device__ bool next(int i, Unit& u) const {
        const long L = (long)i * G + c; if (L >= nwg) return false;
        int wgid = (int)L; { const int q = nwg / NXCD, r = nwg % NXCD, xcd = wgid % NXCD, off = wgid / NXCD; wgid = (xcd < r ? xcd * (q + 1) : r * (q + 1) + (xcd - r) * q) + off; }
        const int nig = WGM * nN, gid = wgid / nig, fm = gid * WGM, gsz = (nM - fm) < WGM ? (nM - fm) : WGM;
        u.pm = fm + ((wgid % nig) % gsz); u.pn = (wgid % nig) / gsz; return true;
    }
    __device__ __forceinline__ void a_ready(const Unit&) const {}
    __device__ __forceinline__ void done(const Unit&) const {}
};

__device__ __forceinline__ unsigned cvt_pk_bf16(float lo, float hi) { unsigned r; asm volatile("v_cvt_pk_bf16_f32 %0, %1, %2" : "=v"(r) : "v"(lo), "v"(hi)); return r; }
typedef float f32x2 __attribute__((ext_vector_type(2)));
typedef unsigned u32x2 __attribute__((ext_vector_type(2)));
__device__ __forceinline__ float sigmoidf_(float x) { return __builtin_amdgcn_rcpf(1.0f + __expf(-x)); }
__device__ __forceinline__ float row_rs(const float* part, int row) {
    const f32x4* p = (const f32x4*)(part + (size_t)row * 16);
    const f32x4 a = p[0], b = p[1], c = p[2], d = p[3];
    const float s = (((a[0] + a[1]) + (a[2] + a[3])) + ((b[0] + b[1]) + (b[2] + b[3]))) + (((c[0] + c[1]) + (c[2] + c[3])) + ((d[0] + d[1]) + (d[2] + d[3])));
    return __builtin_amdgcn_rsqf(s * (1.0f / 1024.0f) + 1e-6f);
}
struct EpiPlainBf16 {
    static constexpr bool PERM = true, AFTER_DRAIN = false;
    bf16_t* O; int ldc;
    __device__ __forceinline__ void operator()(const f32x4 (&acc)[2][2][4][2], const Unit& u, int wr, int wc, int fr, int fq) const {
        const int row0 = u.pm * BM + wr * 64 + fr, col0 = u.pn * BM + wc * 32 + 8 * fq;
#pragma unroll
        for (int ai = 0; ai < 2; ++ai)
#pragma unroll
            for (int m = 0; m < 4; ++m) { bf16_t* rowp = O + (size_t)(row0 + ai * HALF + m * 16) * ldc + col0;
#pragma unroll
                for (int bj = 0; bj < 2; ++bj) { const f32x4 v0 = acc[ai][bj][m][0], v1 = acc[ai][bj][m][1];
                    u32x4 w; w.x = cvt_pk_bf16(v0[0], v0[1]); w.y = cvt_pk_bf16(v0[2], v0[3]); w.z = cvt_pk_bf16(v1[0], v1[1]); w.w = cvt_pk_bf16(v1[2], v1[3]);
                    *(u32x4*)(rowp + bj * HALF) = w; } }
    }
};
struct EpiResid {
    static constexpr bool PERM = false, AFTER_DRAIN = false;
    const float* base; float* outf; bf16_t* hb; float* part; int ldc;
    __device__ __forceinline__ void operator()(const f32x4 (&acc)[2][2][4][2], const Unit& u, int wr, int wc, int fr, int fq) const {
        const int col0 = u.pn * BM + wc * 32 + 4 * fq;
#pragma unroll
        for (int ai = 0; ai < 2; ++ai)
#pragma unroll
            for (int m = 0; m < 4; ++m) { const int row = u.pm * BM + ai * HALF + wr * 64 + m * 16 + fr; const size_t off = (size_t)row * ldc + col0; float s = 0.f;
#pragma unroll
                for (int bj = 0; bj < 2; ++bj)
#pragma unroll
                    for (int n = 0; n < 2; ++n) { const size_t o = off + bj * HALF + n * 16; const f32x4 v = *(const f32x4*)(base + o) + acc[ai][bj][m][n];
                        *(f32x4*)(outf + o) = v; s += (v[0] * v[0] + v[1] * v[1]) + (v[2] * v[2] + v[3] * v[3]);
                        u32x2 w; w.x = cvt_pk_bf16(v[0], v[1]); w.y = cvt_pk_bf16(v[2], v[3]); *(u32x2*)(hb + o) = w; }
                s += __shfl_xor(s, 16); s += __shfl_xor(s, 32);
                if (fq == 0) part[(size_t)row * 16 + u.pn * 4 + wc] = s;
                asm volatile("" ::: "memory"); }
    }
};
struct EpiSwiGLU {
    static constexpr bool PERM = true, AFTER_DRAIN = false;
    bf16_t* O; int ldc; const float* part;
    __device__ __forceinline__ void operator()(const f32x4 (&acc)[2][2][4][2], const Unit& u, int wr, int wc, int fr, int fq) const {
        const int row0 = u.pm * BM + wr * 64 + fr, col0 = u.pn * HALF + wc * 32 + 8 * fq;
#pragma unroll
        for (int ai = 0; ai < 2; ++ai)
#pragma unroll
            for (int m = 0; m < 4; ++m) { const int row = row0 + ai * HALF + m * 16; const float rs = row_rs(part, row);
                float o[8];
#pragma unroll
                for (int n = 0; n < 2; ++n)
#pragma unroll
                    for (int i = 0; i < 4; ++i) { const float g = acc[ai][0][m][n][i] * rs, up = acc[ai][1][m][n][i] * rs; o[n * 4 + i] = g * sigmoidf_(g) * up; }
                u32x4 w; w.x = cvt_pk_bf16(o[0], o[1]); w.y = cvt_pk_bf16(o[2], o[3]); w.z = cvt_pk_bf16(o[4], o[5]); w.w = cvt_pk_bf16(o[6], o[7]);
                *(u32x4*)(O + (size_t)row * ldc + col0) = w; }
    }
};
struct EpiPle {
    static constexpr bool PERM = false, AFTER_DRAIN = false;
    float* h; const bf16_t* pp; const float* part_in; float* part_out; int ldc;
    __device__ __forceinline__ void operator()(const f32x4 (&acc)[2][2][4][2], const Unit& u, int wr, int wc, int fr, int fq) const {
        const int col0 = u.pn * BM + wc * 32 + 4 * fq;
#pragma unroll
        for (int ai = 0; ai < 2; ++ai)
#pragma unroll
            for (int m = 0; m < 4; ++m) { const int row = u.pm * BM + ai * HALF + wr * 64 + m * 16 + fr; const size_t off = (size_t)row * ldc + col0; float s = 0.f;
                const float rs = row_rs(part_in, row);
#pragma unroll
                for (int bj = 0; bj < 2; ++bj)
#pragma unroll
                    for (int n = 0; n < 2; ++n) { const size_t o = off + bj * HALF + n * 16; const f32x4 a = acc[ai][bj][m][n] * rs; const u32x2 pw = *(const u32x2*)(pp + o);
                        f32x4 p; p[0] = __uint_as_float(pw.x << 16); p[1] = __uint_as_float(pw.x & 0xffff0000u); p[2] = __uint_as_float(pw.y << 16); p[3] = __uint_as_float(pw.y & 0xffff0000u);
                        f32x4 v = *(const f32x4*)(h + o);
#pragma unroll
                        for (int i = 0; i < 4; ++i) v[i] += sigmoidf_(a[i]) * p[i];
                        *(f32x4*)(h + o) = v; s += (v[0] * v[0] + v[1] * v[1]) + (v[2] * v[2] + v[3] * v[3]); }
                s += __shfl_xor(s, 16); s += __shfl_xor(s, 32);
                if (fq == 0) part_out[(size_t)row * 16 + u.pn * 4 + wc] = s;
                asm volatile("" ::: "memory"); }
    }
};
template <class Epi, class Sched, bool ALIGN_EPI = false, bool SP2 = false>
__device__ __forceinline__ void gemm_phase(PG8_LAS unsigned char* lds, const Gemm g, const Sched& S, const Epi& E) {
    const int tid = threadIdx.x, wid = __builtin_amdgcn_readfirstlane(tid >> 6), lane = tid & 63, wr = wid >> 2, wc = wid & 3, fr = lane & 15, fq = lane >> 4;
    const int K = g.K, nt = K / BK;
    unsigned voffA[2], voffB[2];
#pragma unroll
    for (int i = 0; i < 2; ++i) { int R, C; stage_rc(tid * 16 + i * 8192, R, C); const int Rb = Epi::PERM ? ((R & ~31) + perm32(R & 31)) : R;
        voffA[i] = (unsigned)(R * K + C) * 2u; voffB[i] = (unsigned)(Rb * K + C) * 2u; }
    const size_t kstep = (size_t)(BK * 2);
    const size_t hstep = (size_t)HALF * K * 2;
    const size_t tstep = 2 * hstep;
    const unsigned ldsw = (unsigned)wid * 1024u;
    const int aoff = lds_byte(wr * 64 + fr, fq * 8), boff = lds_byte(wc * 32 + fr, fq * 8);
#define PG8_SA(b, h) (((b) * 2 + (h)) * HTB)
#define PG8_SB(b, h) ((4 + (b) * 2 + (h)) * HTB)
#define PG8_STAGE(bufoff, gbase, voff) do { _Pragma("unroll") for (int _i = 0; _i < 2; ++_i) \
        __builtin_amdgcn_global_load_lds((const unsigned*)((const char*)(gbase) + (voff)[_i]), (PG8_LAS unsigned*)(lds + (bufoff) + ldsw + _i * 8192), 16, 0, 0); } while (0)
#define PG8_LDA(dst, b, h) do { _Pragma("unroll") for (int m = 0; m < 4; ++m) _Pragma("unroll") for (int k = 0; k < 2; ++k) dst[m][k] = *(const PG8_LAS bf16x8*)(lds + PG8_SA(b, h) + aoff + m * 2048 + k * 1024); } while (0)
#define PG8_LDB(dst, b, h) do { _Pragma("unroll") for (int n = 0; n < 2; ++n) _Pragma("unroll") for (int k = 0; k < 2; ++k) dst[n][k] = *(const PG8_LAS bf16x8*)(lds + PG8_SB(b, h) + boff + n * 2048 + k * 1024); } while (0)
#define PG8_MMA(ai, bj, At, Bt) do { __builtin_amdgcn_s_setprio(1); _Pragma("unroll") for (int m = 0; m < 4; ++m) _Pragma("unroll") for (int n = 0; n < 2; ++n) _Pragma("unroll") for (int k = 0; k < 2; ++k) \
        acc[ai][bj][m][n] = __builtin_amdgcn_mfma_f32_16x16x32_bf16(Bt[n][k], At[m][k], acc[ai][bj][m][n], 0, 0, 0); __builtin_amdgcn_s_setprio(0); } while (0)
#define PG8_WAIT_V(n) asm volatile("s_waitcnt vmcnt(" #n ")" ::: "memory")
#define PG8_WAIT_L(n) asm volatile("s_waitcnt lgkmcnt(" #n ")" ::: "memory")
#define PG8_BAR __builtin_amdgcn_s_barrier()
#define PG8_SCHED __builtin_amdgcn_sched_barrier(0)
    Unit cur, nxt; int ui = 0;
    if (!S.next(0, cur)) return;
    f32x4 acc[2][2][4][2];
#pragma unroll
    for (int a = 0; a < 2; ++a)
#pragma unroll
        for (int b = 0; b < 2; ++b)
#pragma unroll
            for (int m = 0; m < 4; ++m)
#pragma unroll
                for (int n = 0; n < 2; ++n) acc[a][b][m][n] = (f32x4){0.f, 0.f, 0.f, 0.f};
    bf16x8 At[4][2], B0[2][2], B1[2][2];
    const char* cA = (const char*)g.A + (size_t)cur.pm * tstep; const char* cB = (const char*)g.Bt + (size_t)cur.pn * tstep;
    S.a_ready(cur);
    if constexpr (SP2) {
        PG8_STAGE(PG8_SB(0, 0), cB, voffB); PG8_STAGE(PG8_SB(0, 1), cB + hstep, voffB); PG8_STAGE(PG8_SA(0, 0), cA, voffA); PG8_STAGE(PG8_SA(0, 1), cA + hstep, voffA);
        if (wr == 1) PG8_BAR;
        PG8_WAIT_V(2); PG8_BAR;
        PG8_STAGE(PG8_SB(1, 0), cB + kstep, voffB); PG8_STAGE(PG8_SA(1, 0), cA + kstep, voffA); PG8_STAGE(PG8_SB(1, 1), cB + hstep + kstep, voffB);
        PG8_WAIT_V(6); PG8_BAR;
    } else {
        PG8_STAGE(PG8_SB(0, 0), cB, voffB); PG8_STAGE(PG8_SA(0, 0), cA, voffA); PG8_STAGE(PG8_SB(0, 1), cB + hstep, voffB); PG8_STAGE(PG8_SA(0, 1), cA + hstep, voffA);
        if (wr == 1) PG8_BAR;
        PG8_WAIT_V(4); PG8_BAR;
        PG8_STAGE(PG8_SB(1, 0), cB + kstep, voffB); PG8_STAGE(PG8_SA(1, 0), cA + kstep, voffA); PG8_STAGE(PG8_SB(1, 1), cB + hstep + kstep, voffB);
        PG8_WAIT_V(6); PG8_BAR;
    }
    for (;;) {
        const bool has_next = S.next(ui + 1, nxt);
        const char* nA = has_next ? (const char*)g.A + (size_t)nxt.pm * tstep : cA; const char* nB = has_next ? (const char*)g.Bt + (size_t)nxt.pn * tstep : cB;
        for (int t = 0; t < nt; t += 2) {
            const bool last = (t == nt - 2);
            const char* a1 = cA + (size_t)(t + 1) * kstep;
            const char* a2 = last ? nA : cA + (size_t)(t + 2) * kstep; const char* b2 = last ? nB : cB + (size_t)(t + 2) * kstep;
            const char* a3 = a2 + kstep; const char* b3 = b2 + kstep;
            if (last && has_next) S.a_ready(nxt);
            if constexpr (SP2) {
            PG8_LDB(B0, 0, 0); PG8_LDB(B1, 0, 1); PG8_SCHED; PG8_LDA(At, 0, 0); PG8_STAGE(PG8_SA(1, 1), a1 + hstep, voffA);
            PG8_WAIT_V(8); PG8_WAIT_L(0); PG8_BAR; PG8_MMA(0, 0, At, B0); PG8_MMA(0, 1, At, B1); PG8_BAR; PG8_SCHED;
            PG8_LDA(At, 0, 1); PG8_STAGE(PG8_SB(0, 0), b2, voffB); PG8_STAGE(PG8_SB(0, 1), b2 + hstep, voffB); PG8_STAGE(PG8_SA(0, 0), a2, voffA);
            PG8_WAIT_V(8); PG8_WAIT_L(0); PG8_BAR; PG8_MMA(1, 0, At, B0); PG8_MMA(1, 1, At, B1); PG8_BAR; PG8_SCHED;
            PG8_LDB(B0, 1, 0); PG8_LDB(B1, 1, 1); PG8_SCHED; PG8_LDA(At, 1, 0); PG8_STAGE(PG8_SA(0, 1), a2 + hstep, voffA);
            PG8_WAIT_V(8); PG8_WAIT_L(0); PG8_BAR; PG8_MMA(0, 0, At, B0); PG8_MMA(0, 1, At, B1); PG8_BAR; PG8_SCHED;
            PG8_LDA(At, 1, 1); PG8_STAGE(PG8_SB(1, 0), b3, voffB); PG8_STAGE(PG8_SB(1, 1), b3 + hstep, voffB); PG8_STAGE(PG8_SA(1, 0), a3, voffA);
            PG8_WAIT_V(8); PG8_WAIT_L(0); PG8_BAR; PG8_MMA(1, 0, At, B0); PG8_MMA(1, 1, At, B1); PG8_BAR; PG8_SCHED;
            } else {
            PG8_LDB(B0, 0, 0); PG8_SCHED; PG8_LDA(At, 0, 0); PG8_STAGE(PG8_SA(1, 1), a1 + hstep, voffA);
            PG8_WAIT_L(8); PG8_BAR; PG8_WAIT_L(0); PG8_MMA(0, 0, At, B0); PG8_BAR; PG8_SCHED;
            PG8_LDB(B1, 0, 1); PG8_STAGE(PG8_SB(0, 0), b2, voffB);
            PG8_BAR; PG8_WAIT_L(0); PG8_MMA(0, 1, At, B1); PG8_BAR;
            PG8_LDA(At, 0, 1); PG8_STAGE(PG8_SA(0, 0), a2, voffA);
            PG8_BAR; PG8_WAIT_L(0); PG8_MMA(1, 0, At, B0); PG8_BAR; PG8_SCHED;
            PG8_STAGE(PG8_SB(0, 1), b2 + hstep, voffB);
            PG8_WAIT_V(6); PG8_BAR; PG8_MMA(1, 1, At, B1); PG8_BAR;
            PG8_LDB(B0, 1, 0); PG8_SCHED; PG8_LDA(At, 1, 0); PG8_STAGE(PG8_SA(0, 1), a2 + hstep, voffA);
            PG8_WAIT_L(8); PG8_BAR; PG8_WAIT_L(0); PG8_MMA(0, 0, At, B0); PG8_BAR; PG8_SCHED;
            PG8_LDB(B1, 1, 1); PG8_STAGE(PG8_SB(1, 0), b3, voffB);
            PG8_BAR; PG8_WAIT_L(0); PG8_MMA(0, 1, At, B1); PG8_BAR;
            PG8_LDA(At, 1, 1); PG8_STAGE(PG8_SA(1, 0), a3, voffA);
            PG8_BAR; PG8_WAIT_L(0); PG8_MMA(1, 0, At, B0); PG8_BAR; PG8_SCHED;
            PG8_STAGE(PG8_SB(1, 1), b3 + hstep, voffB);
            PG8_WAIT_V(6); PG8_BAR; PG8_MMA(1, 1, At, B1); PG8_BAR;
            }
        }
        if constexpr (ALIGN_EPI) { if (wr == 0) PG8_BAR; }
        if constexpr (!Epi::AFTER_DRAIN) { E(acc, cur, wr, wc, fr, fq); S.done(cur); }
        if (!has_next) break;
#pragma unroll
        for (int a = 0; a < 2; ++a)
#pragma unroll
            for (int b = 0; b < 2; ++b)
#pragma unroll
                for (int m = 0; m < 4; ++m)
#pragma unroll
                    for (int n = 0; n < 2; ++n) acc[a][b][m][n] = (f32x4){0.f, 0.f, 0.f, 0.f};
        cur = nxt; cA = nA; cB = nB; ++ui;
        if constexpr (ALIGN_EPI) { if (wr == 1) PG8_BAR; }
    }
    PG8_WAIT_V(0);
    if constexpr (!ALIGN_EPI) { if (wr == 0) PG8_BAR; }
    PG8_BAR;
    if constexpr (Epi::AFTER_DRAIN) { E.fused(acc, cur, wr, wc, fr, fq, lds, wid, lane); S.done(cur); }
#undef PG8_SA
#undef PG8_SB
#undef PG8_STAGE
#undef PG8_LDA
#undef PG8_LDB
#undef PG8_MMA
#undef PG8_WAIT_V
#undef PG8_WAIT_L
#undef PG8_BAR
#undef PG8_SCHED
}
}

namespace cg = cooperative_groups;
#ifndef MK_N_LAUNCHES
#define MK_N_LAUNCHES 1
#endif
constexpr int N_PHASES = 8;
constexpr int NWAVES = 8, NTHR = 512;
constexpr int BATCH = 16, SEQ = 2048, DM = 1024, M = BATCH * SEQ, PLE = 256, CW = 512, RH = 4, RD = 128, INC = 3584, FF = 2816, CHUNK = 128, NCH = SEQ / CHUNK;
constexpr size_t MiB = 1u << 20;
constexpr size_t WS_PART = 0;
constexpr size_t WS_ROPE = 6 * MiB;
constexpr size_t WS_WIN = 8 * MiB, WS_WOUT = 15 * MiB, WS_WGU = 17 * MiB, WS_WDN = 28 * MiB, WS_WPG = 34 * MiB, WS_WPP = 36 * MiB;
constexpr size_t WS_XN = 40 * MiB;
constexpr size_t WS_PB = 104 * MiB;
constexpr size_t WS_PP = 120 * MiB;
constexpr size_t WS_PROJ = 184 * MiB;
constexpr size_t WS_Y = 408 * MiB;
constexpr size_t WS_END = 472 * MiB;
constexpr int LDS_BYTES = 163840;

#define LAS __attribute__((address_space(3)))
typedef unsigned short bf16;
typedef unsigned v4u __attribute__((ext_vector_type(4)));
typedef unsigned v2u __attribute__((ext_vector_type(2)));
typedef float f32x4 __attribute__((ext_vector_type(4)));
typedef short bf16x8 __attribute__((ext_vector_type(8)));
#define LDS_WAIT() asm volatile("s_waitcnt lgkmcnt(0)" ::: "memory")
#define LBAR() do { asm volatile("s_waitcnt lgkmcnt(0)" ::: "memory"); __builtin_amdgcn_s_barrier(); asm volatile("" ::: "memory"); } while (0)
__device__ __forceinline__ unsigned f2bf(float f) { unsigned u = __builtin_bit_cast(unsigned, f); return (u + 0x7fffu + ((u >> 16) & 1u)) >> 16; }
__device__ __forceinline__ unsigned pk2(float lo, float hi) { return pg8::cvt_pk_bf16(lo, hi); }
__device__ __forceinline__ float bflo(unsigned w) { return __uint_as_float(w << 16); }
__device__ __forceinline__ float bfhi(unsigned w) { return __uint_as_float(w & 0xffff0000u); }
__device__ __forceinline__ float wave_sum(float v) {
#pragma unroll
    for (int o = 1; o < 64; o <<= 1) v += __shfl_xor(v, o);
    return v;
}

__device__ __forceinline__ void p0_transpose_item(const float* W, const float* gain, int K, int N, bf16* WT, int k0, int n0, int drow0, LAS float* scr, int lane) {
#pragma unroll 8
    for (int i = 0; i < 32; ++i) { const int kk = 2 * i + (lane >> 5); const float g = gain ? gain[k0 + kk] : 1.0f; scr[kk * 33 + (lane & 31)] = W[(size_t)(k0 + kk) * N + n0 + (lane & 31)] * g; }
    LDS_WAIT(); asm volatile("" ::: "memory");
    const int c = lane & 7;
#pragma unroll
    for (int j = 0; j < 4; ++j) { const int n = (lane >> 3) + 8 * j; const LAS float* s = scr + (8 * c) * 33 + n;
        v4u o; o.x = pk2(s[0 * 33], s[1 * 33]); o.y = pk2(s[2 * 33], s[3 * 33]); o.z = pk2(s[4 * 33], s[5 * 33]); o.w = pk2(s[6 * 33], s[7 * 33]);
        *(v4u*)(WT + (size_t)(drow0 + n0 + n) * K + k0 + 8 * c) = o; }
    LDS_WAIT(); asm volatile("" ::: "memory");
}

struct Args { const float* in[15]; float* out; unsigned char* ws; int ph_lo, ph_hi; };

__device__ __forceinline__ void p0_prologue(const Args& a, LAS unsigned char* lds, int vcu, int G, int tid) {
    const int lane = tid & 63, wave = __builtin_amdgcn_readfirstlane(tid >> 6);
    unsigned char* ws = a.ws;
    LAS float* scr = (LAS float*)(lds + wave * 16384);
    const int gw = vcu * NWAVES + wave, NGW = G * NWAVES;
    const float *g_mix = a.in[2], *w_in = a.in[3], *w_out = a.in[6], *g_ffn = a.in[7], *w_gate = a.in[8], *w_up = a.in[9], *w_down = a.in[10], *g_ple = a.in[11], *w_pg = a.in[12], *w_pp = a.in[13];
    constexpr int I_IN = 16 * (INC / 32), I_OUT = 16 * 32, I_G = 16 * (FF / 32), I_DN = (FF / 64) * 32, I_PG = 16 * 32, I_PP = 4 * 32;
    constexpr int NITEMS = I_IN + I_OUT + 2 * I_G + I_DN + I_PG + I_PP;
    for (int it = gw; it < NITEMS; it += NGW) {
        int r = it;
        if (r < I_IN) { const int nb = INC / 32; p0_transpose_item(w_in, g_mix, DM, INC, (bf16*)(ws + WS_WIN), 64 * (r / nb), 32 * (r % nb), 0, scr, lane); continue; } r -= I_IN;
        if (r < I_OUT) { p0_transpose_item(w_out, nullptr, DM, DM, (bf16*)(ws + WS_WOUT), 64 * (r / 32), 32 * (r % 32), 0, scr, lane); continue; } r -= I_OUT;
        if (r < I_G) { const int nb = FF / 32, n0 = 32 * (r % nb); p0_transpose_item(w_gate, g_ffn, DM, FF, (bf16*)(ws + WS_WGU), 64 * (r / nb), n0, (n0 / 128) * 256 + (n0 % 128) - n0, scr, lane); continue; } r -= I_G;
        if (r < I_G) { const int nb = FF / 32, n0 = 32 * (r % nb); p0_transpose_item(w_up, g_ffn, DM, FF, (bf16*)(ws + WS_WGU), 64 * (r / nb), n0, (n0 / 128) * 256 + 128 + (n0 % 128) - n0, scr, lane); continue; } r -= I_G;
        if (r < I_DN) { p0_transpose_item(w_down, nullptr, FF, DM, (bf16*)(ws + WS_WDN), 64 * (r / 32), 32 * (r % 32), 0, scr, lane); continue; } r -= I_DN;
        if (r < I_PG) { p0_transpose_item(w_pg, g_ple, DM, DM, (bf16*)(ws + WS_WPG), 64 * (r / 32), 32 * (r % 32), 0, scr, lane); continue; } r -= I_PG;
        p0_transpose_item(w_pp, nullptr, PLE, DM, (bf16*)(ws + WS_WPP), 64 * (r / 32), 32 * (r % 32), 0, scr, lane);
    }
    const float* x = a.in[0]; bf16* XN = (bf16*)(ws + WS_XN);
    for (int m = gw; m < M; m += NGW) {
        const f32x4* xr = (const f32x4*)(x + (size_t)m * DM) + lane;
        f32x4 v[4]; float s = 0.f;
#pragma unroll
        for (int j = 0; j < 4; ++j) { v[j] = xr[64 * j]; s += (v[j][0] * v[j][0] + v[j][1] * v[j][1]) + (v[j][2] * v[j][2] + v[j][3] * v[j][3]); }
        const float rs = __builtin_amdgcn_rsqf(wave_sum(s) * (1.0f / DM) + 1e-6f);
        v2u* o8 = (v2u*)(XN + (size_t)m * DM) + lane;
#pragma unroll
        for (int j = 0; j < 4; ++j) { v2u o; o.x = pk2(v[j][0] * rs, v[j][1] * rs); o.y = pk2(v[j][2] * rs, v[j][3] * rs); o8[64 * j] = o; }
    }
    { const float* p = a.in[1]; bf16* PB = (bf16*)(ws + WS_PB); const int gt = vcu * NTHR + tid, GT = G * NTHR;
      for (int i = gt; i < M * PLE / 8; i += GT) { const f32x4 u0 = ((const f32x4*)p)[2 * i], u1 = ((const f32x4*)p)[2 * i + 1];
          v4u o; o.x = pk2(u0[0], u0[1]); o.y = pk2(u0[2], u0[3]); o.z = pk2(u1[0], u1[1]); o.w = pk2(u1[2], u1[3]); ((v4u*)PB)[i] = o; }
      float* rc = (float*)(ws + WS_ROPE); float* rsn = rc + SEQ * 64;
      for (int i = gt; i < SEQ * 64; i += GT) { const int pos = i >> 6, j = i & 63;
          const float inv_freq = exp2f(-(float)j * (13.287712379549449f / 64.0f));
          const float ang = (float)pos * inv_freq;
          double rev = (double)ang * 0.15915494309189535; rev -= floor(rev); const float rf = (float)rev;
          rc[i] = __builtin_amdgcn_cosf(rf); rsn[i] = __builtin_amdgcn_sinf(rf); }
    }
}

__device__ __forceinline__ void conv_run(const bf16* proj, bf16* Y, const float* conv_w, int run, int lane) {
    const int c0 = 8 * lane, t0 = run * 16, s0 = t0 % SEQ;
    float w0[8], w1[8], w2[8], z1[8], z2[8];
#pragma unroll
    for (int i = 0; i < 8; ++i) { w0[i] = conv_w[c0 + i]; w1[i] = conv_w[CW + c0 + i]; w2[i] = conv_w[2 * CW + c0 + i]; z1[i] = 0.f; z2[i] = 0.f; }
    if (s0 != 0) {
        const v4u a2 = *(const v4u*)(proj + (size_t)(t0 - 2) * INC + CW + c0), b2 = *(const v4u*)(proj + (size_t)(t0 - 2) * INC + 2 * CW + c0);
        const v4u a1 = *(const v4u*)(proj + (size_t)(t0 - 1) * INC + CW + c0), b1 = *(const v4u*)(proj + (size_t)(t0 - 1) * INC + 2 * CW + c0);
#pragma unroll
        for (int i = 0; i < 4; ++i) { z2[2 * i] = bflo(a2[i]) * bflo(b2[i]); z2[2 * i + 1] = bfhi(a2[i]) * bfhi(b2[i]); z1[2 * i] = bflo(a1[i]) * bflo(b1[i]); z1[2 * i + 1] = bfhi(a1[i]) * bfhi(b1[i]); }
    }
#pragma unroll 4
    for (int t = 0; t < 16; ++t) { const bf16* pr = proj + (size_t)(t0 + t) * INC + c0;
        const v4u cb = *(const v4u*)pr, cc = *(const v4u*)(pr + CW), cx = *(const v4u*)(pr + 2 * CW);
        float y[8];
#pragma unroll
        for (int i = 0; i < 4; ++i) {
            const float za = bflo(cc[i]) * bflo(cx[i]), zb = bfhi(cc[i]) * bfhi(cx[i]);
            y[2 * i] = bflo(cb[i]) * (w0[2 * i] * z2[2 * i] + w1[2 * i] * z1[2 * i] + w2[2 * i] * za);
            y[2 * i + 1] = bfhi(cb[i]) * (w0[2 * i + 1] * z2[2 * i + 1] + w1[2 * i + 1] * z1[2 * i + 1] + w2[2 * i + 1] * zb);
            z2[2 * i] = z1[2 * i]; z2[2 * i + 1] = z1[2 * i + 1]; z1[2 * i] = za; z1[2 * i + 1] = zb; }
        v4u o; o.x = pk2(y[0], y[1]); o.y = pk2(y[2], y[3]); o.z = pk2(y[4], y[5]); o.w = pk2(y[6], y[7]);
        *(v4u*)(Y + (size_t)(t0 + t) * DM + c0) = o; }
}

constexpr int TP = 136;
constexpr int R_Q = 0, R_P = 8704, R_K = 17408, R_KDT = R_K + 34816, R_VT = R_KDT + 34816, R_ST = R_VT + 34816, R_STAT = R_ST + 34816;
static_assert(R_STAT + 1024 <= LDS_BYTES, "retention LDS map");
#define MFMA16(a, b, c) __builtin_amdgcn_mfma_f32_16x16x32_bf16(a, b, c, 0, 0, 0)
#define OPQ(x) asm volatile("" : "+v"(x))
#define LDF(addr) (*(const LAS bf16x8*)(size_t)(addr))
#define LDSW(T, addr) (*(LAS T*)(size_t)(addr))

__device__ __forceinline__ void retention_unit(LAS unsigned char* lds, const bf16* proj, bf16* Y, const float* ropec, const float* ropes, const float* ret_gn, int b, int h, int cq, int tid) {
    const int lane = tid & 63, w = __builtin_amdgcn_readfirstlane(tid >> 6), fr = lane & 15, fq = lane >> 4;
    const float lg = log2f(1.0f - exp2f(-5.0f - (float)h));
    const float cd = exp2f(lg * 128.0f);
    const int kd0 = 8 * (tid & 7), km = 2 * (tid >> 3);
    const int ve0 = 8 * (tid & 15), vm0 = 4 * (tid >> 4);
    const int qd0 = 4 * (tid & 15), qr = tid >> 4;
    const int rt = w >> 2, ct = w & 3;
    const int cloc = 32 * cq + 16 * rt + fr;
    const float qdec = exp2f(lg * (float)(cloc + 1));
    const bf16* pb = proj + (size_t)b * SEQ * INC + h * RD;
    const unsigned L = (unsigned)(size_t)lds, fo = (unsigned)(fr * TP + 8 * fq) * 2u;
    unsigned bQ = L + R_Q + 16 * rt * TP * 2 + fo, bK = L + R_K + 32 * ct * TP * 2 + fo, bST = L + R_ST + 32 * ct * TP * 2 + fo, bVT = L + R_VT + 32 * ct * TP * 2 + fo;
    unsigned bVTa = L + R_VT + 16 * w * TP * 2 + fo, bKD = L + R_KDT + fo;
    unsigned wK = L + R_K + (km * TP + kd0) * 2, wKD = L + R_KDT + (kd0 * TP + km) * 2, wVT = L + R_VT + (ve0 * TP + vm0) * 2, wQ = L + R_Q + (qr * TP + qd0) * 2;
    unsigned wP = L + R_P + ((16 * rt + fr) * TP + 32 * ct + 4 * fq) * 2, wST = L + R_ST + ((16 * w + fr) * TP + 4 * fq) * 2;
    unsigned wSTAT = L + R_STAT + ((16 * rt + fr) * 4 + ct) * 8, rSTAT = L + R_STAT + (16 * rt + fr) * 32;
    OPQ(bQ); OPQ(bK); OPQ(bST); OPQ(bVT); OPQ(bVTa); OPQ(bKD); OPQ(wK); OPQ(wKD); OPQ(wVT); OPQ(wQ); OPQ(wP); OPQ(wST); OPQ(wSTAT); OPQ(rSTAT);
    f32x4 state[8];
#pragma unroll
    for (int j = 0; j < 8; ++j) state[j] = (f32x4){0.f, 0.f, 0.f, 0.f};
#pragma unroll
    for (int j = 0; j < 8; ++j) LDSW(v2u, wST + j * 32) = (v2u){0u, 0u};
    v4u kraw[4], vraw[4]; v2u qraw[2];
#define RET_LOAD(n) do { const bf16* p0_ = pb + (size_t)((n) * CHUNK) * INC; \
        kraw[0] = *(const v4u*)(p0_ + (size_t)km * INC + 2048 + kd0); kraw[1] = *(const v4u*)(p0_ + (size_t)km * INC + 2048 + 64 + kd0); \
        kraw[2] = *(const v4u*)(p0_ + (size_t)(km + 1) * INC + 2048 + kd0); kraw[3] = *(const v4u*)(p0_ + (size_t)(km + 1) * INC + 2048 + 64 + kd0); \
        _Pragma("unroll") for (int i_ = 0; i_ < 4; ++i_) vraw[i_] = *(const v4u*)(p0_ + (size_t)(vm0 + i_) * INC + 2560 + ve0); \
        qraw[0] = *(const v2u*)(p0_ + (size_t)(32 * cq + qr) * INC + 1536 + qd0); qraw[1] = *(const v2u*)(p0_ + (size_t)(32 * cq + qr) * INC + 1536 + 64 + qd0); } while (0)
    RET_LOAD(0);
#pragma unroll 1
    for (int n = 0; n < NCH; ++n) {
        {
            float y1[2][8], y2[2][8];
#pragma unroll
            for (int r = 0; r < 2; ++r) { const int pos = n * CHUNK + km + r; const f32x4* cp = (const f32x4*)(ropec + pos * 64 + kd0); const f32x4* sp = (const f32x4*)(ropes + pos * 64 + kd0);
                const f32x4 c0 = cp[0], c1 = cp[1], s0 = sp[0], s1 = sp[1]; const v4u a = kraw[2 * r], bq = kraw[2 * r + 1];
                const float cs[8] = {c0[0], c0[1], c0[2], c0[3], c1[0], c1[1], c1[2], c1[3]}, sn[8] = {s0[0], s0[1], s0[2], s0[3], s1[0], s1[1], s1[2], s1[3]};
#pragma unroll
                for (int i = 0; i < 4; ++i) { const float cA = cs[2 * i], cB = cs[2 * i + 1], sA = sn[2 * i], sB = sn[2 * i + 1];
                    const float x1a = bflo(a[i]), x1b = bfhi(a[i]), x2a = bflo(bq[i]), x2b = bfhi(bq[i]);
                    y1[r][2 * i] = (x1a * cA - x2a * sA) * 0.08838834764831845f; y1[r][2 * i + 1] = (x1b * cB - x2b * sB) * 0.08838834764831845f;
                    y2[r][2 * i] = (x2a * cA + x1a * sA) * 0.08838834764831845f; y2[r][2 * i + 1] = (x2b * cB + x1b * sB) * 0.08838834764831845f; }
                v4u o1, o2; o1.x = pk2(y1[r][0], y1[r][1]); o1.y = pk2(y1[r][2], y1[r][3]); o1.z = pk2(y1[r][4], y1[r][5]); o1.w = pk2(y1[r][6], y1[r][7]);
                o2.x = pk2(y2[r][0], y2[r][1]); o2.y = pk2(y2[r][2], y2[r][3]); o2.z = pk2(y2[r][4], y2[r][5]); o2.w = pk2(y2[r][6], y2[r][7]);
                LDSW(v4u, wK + r * TP * 2) = o1; LDSW(v4u, wK + r * TP * 2 + 128) = o2; }
            const float d0 = exp2f(lg * (float)(127 - km)), d1 = exp2f(lg * (float)(126 - km));
#pragma unroll
            for (int i = 0; i < 8; ++i) { LDSW(unsigned, wKD + i * TP * 2) = pk2(y1[0][i] * d0, y1[1][i] * d1);
                                          LDSW(unsigned, wKD + (64 + i) * TP * 2) = pk2(y2[0][i] * d0, y2[1][i] * d1); }
        }
        {
#pragma unroll
            for (int i = 0; i < 4; ++i) { const unsigned a0 = vraw[0][i], a1 = vraw[1][i], a2 = vraw[2][i], a3 = vraw[3][i];
                v2u lo, hi; lo.x = (a0 & 0xffffu) | (a1 << 16); lo.y = (a2 & 0xffffu) | (a3 << 16); hi.x = (a0 >> 16) | (a1 & 0xffff0000u); hi.y = (a2 >> 16) | (a3 & 0xffff0000u);
                LDSW(v2u, wVT + (2 * i) * TP * 2) = lo; LDSW(v2u, wVT + (2 * i + 1) * TP * 2) = hi; }
        }
        {
            const int pos = n * CHUNK + 32 * cq + qr; const f32x4 c = *(const f32x4*)(ropec + pos * 64 + qd0), s = *(const f32x4*)(ropes + pos * 64 + qd0);
            const float x1[4] = {bflo(qraw[0].x), bfhi(qraw[0].x), bflo(qraw[0].y), bfhi(qraw[0].y)}, x2[4] = {bflo(qraw[1].x), bfhi(qraw[1].x), bflo(qraw[1].y), bfhi(qraw[1].y)};
            v2u o1, o2; o1.x = pk2(x1[0] * c[0] - x2[0] * s[0], x1[1] * c[1] - x2[1] * s[1]); o1.y = pk2(x1[2] * c[2] - x2[2] * s[2], x1[3] * c[3] - x2[3] * s[3]);
            o2.x = pk2(x2[0] * c[0] + x1[0] * s[0], x2[1] * c[1] + x1[1] * s[1]); o2.y = pk2(x2[2] * c[2] + x1[2] * s[2], x2[3] * c[3] + x1[3] * s[3]);
            LDSW(v2u, wQ) = o1; LDSW(v2u, wQ + 128) = o2;
        }
        if (n + 1 < NCH) RET_LOAD(n + 1);
        const size_t grow = (size_t)b * SEQ + n * CHUNK + cloc;
        v2u graw[2];
#pragma unroll
        for (int jt = 0; jt < 2; ++jt) graw[jt] = *(const v2u*)(proj + grow * INC + 3072 + h * RD + 32 * ct + 16 * jt + 4 * fq);
        LBAR();
        f32x4 accC[2] = {(f32x4){0.f, 0.f, 0.f, 0.f}, (f32x4){0.f, 0.f, 0.f, 0.f}}, accS[2] = {(f32x4){0.f, 0.f, 0.f, 0.f}, (f32x4){0.f, 0.f, 0.f, 0.f}};
#pragma unroll
        for (int ks = 0; ks < 4; ++ks) { const bf16x8 af = LDF(bQ + ks * 64);
#pragma unroll
            for (int jt = 0; jt < 2; ++jt) { accC[jt] = MFMA16(LDF(bST + jt * 16 * TP * 2 + ks * 64), af, accC[jt]);
                                             accS[jt] = MFMA16(LDF(bK + jt * 16 * TP * 2 + ks * 64), af, accS[jt]); } __builtin_amdgcn_sched_barrier(0); }
#pragma unroll
        for (int jt = 0; jt < 2; ++jt) { const int m0 = 32 * ct + 16 * jt + 4 * fq; float pv[4];
#pragma unroll
            for (int r = 0; r < 4; ++r) { const int dm = cloc - (m0 + r); pv[r] = dm >= 0 ? accS[jt][r] * exp2f(lg * (float)dm) : 0.f; }
            LDSW(v2u, wP + jt * 32) = (v2u){pk2(pv[0], pv[1]), pk2(pv[2], pv[3])}; }
        LBAR();
#pragma unroll
        for (int jt = 0; jt < 2; ++jt) accC[jt] = accC[jt] * qdec;
#pragma unroll
        for (int ks = 0; ks < 4; ++ks) { const bf16x8 af = LDF(bQ + (R_P - R_Q) + ks * 64);
#pragma unroll
            for (int jt = 0; jt < 2; ++jt) accC[jt] = MFMA16(LDF(bVT + jt * 16 * TP * 2 + ks * 64), af, accC[jt]); __builtin_amdgcn_sched_barrier(0); }
#pragma unroll
        for (int j = 0; j < 8; ++j) state[j] = state[j] * cd;
#pragma unroll
        for (int ks = 0; ks < 4; ++ks) { const bf16x8 af = LDF(bVTa + ks * 64);
#pragma unroll
            for (int j = 0; j < 8; ++j) state[j] = MFMA16(LDF(bKD + j * 16 * TP * 2 + ks * 64), af, state[j]); __builtin_amdgcn_sched_barrier(0); }
#pragma unroll
        for (int j = 0; j < 8; ++j) LDSW(v2u, wST + j * 32) = (v2u){pk2(state[j][0], state[j][1]), pk2(state[j][2], state[j][3])};
        { float s = 0.f, ss = 0.f;
#pragma unroll
          for (int jt = 0; jt < 2; ++jt)
#pragma unroll
              for (int r = 0; r < 4; ++r) { s += accC[jt][r]; ss += accC[jt][r] * accC[jt][r]; }
          s += __shfl_xor(s, 16); s += __shfl_xor(s, 32); ss += __shfl_xor(ss, 16); ss += __shfl_xor(ss, 32);
          if (fq == 0) { LDSW(float, wSTAT) = s; LDSW(float, wSTAT + 4) = ss; } }
        LBAR();
        { const f32x4 u0 = LDSW(f32x4, rSTAT), u1 = LDSW(f32x4, rSTAT + 16);
          const float mean = ((u0[0] + u0[2]) + (u1[0] + u1[2])) * (1.0f / 128.0f), ex2 = ((u0[1] + u0[3]) + (u1[1] + u1[3])) * (1.0f / 128.0f);
          const float rstd = __builtin_amdgcn_rsqf(fmaxf(ex2 - mean * mean, 0.f) + 1e-6f);
#pragma unroll
          for (int jt = 0; jt < 2; ++jt) { const int e0 = 32 * ct + 16 * jt + 4 * fq; const f32x4 gn = *(const f32x4*)(ret_gn + h * RD + e0);
              const float g[4] = {bflo(graw[jt].x), bfhi(graw[jt].x), bflo(graw[jt].y), bfhi(graw[jt].y)}; float o[4];
#pragma unroll
              for (int r = 0; r < 4; ++r) o[r] = (accC[jt][r] - mean) * rstd * gn[r] * (g[r] * pg8::sigmoidf_(g[r]));
              *(v2u*)(Y + grow * DM + CW + h * RD + e0) = (v2u){pk2(o[0], o[1]), pk2(o[2], o[3])}; } }
    }
#undef RET_LOAD
    LBAR();
}

__global__ void __launch_bounds__(NTHR, 2) mk_fwd(Args args) {
    extern __shared__ __attribute__((aligned(16))) unsigned char lds_raw[];
    LAS unsigned char* lds = (LAS unsigned char*)lds_raw;
    cg::grid_group grid = cg::this_grid();
    const int tid = threadIdx.x, lane = tid & 63, wave = __builtin_amdgcn_readfirstlane(tid >> 6);
    const int G = gridDim.x, bx = blockIdx.x, vcu = (G % 8 == 0) ? (bx % 8) * (G / 8) + bx / 8 : bx;
    unsigned char* ws = args.ws;
    const int lo = args.ph_lo, hi = args.ph_hi;
#define IN(k) (lo <= (k) && (k) < hi)
#define SEAM(k) do { if (IN(k) && IN((k) + 1)) grid.sync(); } while (0)
    float* part1 = (float*)(ws + WS_PART); float* part2 = part1 + (size_t)M * 16; float* part3 = part2 + (size_t)M * 16;
    bf16* XN = (bf16*)(ws + WS_XN); bf16* PB = (bf16*)(ws + WS_PB); bf16* PP = (bf16*)(ws + WS_PP); bf16* PROJ = (bf16*)(ws + WS_PROJ); bf16* ACT = (bf16*)(ws + WS_PROJ); bf16* Y = (bf16*)(ws + WS_Y);
    float* H = args.out;

    if (IN(0)) { p0_prologue(args, lds, vcu, G, tid); __syncthreads(); }
    SEAM(0);
    if (IN(1)) {
        { pg8::Gemm g{XN, (const bf16*)(ws + WS_WIN), M, INC, DM}; pg8::StaticOrder S; S.init(M, INC, G, bx); pg8::EpiPlainBf16 E{PROJ, INC};
          pg8::gemm_phase<pg8::EpiPlainBf16, pg8::StaticOrder, true, true>(lds, g, S, E); }
        { pg8::Gemm g{PB, (const bf16*)(ws + WS_WPP), M, DM, PLE}; pg8::StaticOrder S; S.init(M, DM, G, bx); pg8::EpiPlainBf16 E{PP, DM};
          pg8::gemm_phase<pg8::EpiPlainBf16, pg8::StaticOrder, true, true>(lds, g, S, E); }
    }
    SEAM(1);
    if (IN(2)) {
        for (int run = vcu * NWAVES + wave; run < M / 16; run += G * NWAVES) conv_run(PROJ, Y, args.in[4], run, lane);
        const float* rc = (const float*)(ws + WS_ROPE);
        for (int u = vcu; u < BATCH * RH * 4; u += G) retention_unit(lds, PROJ, Y, rc, rc + SEQ * 64, args.in[5], u >> 4, (u >> 2) & 3, u & 3, tid);
    }
    SEAM(2);
    if (IN(3)) {
        pg8::Gemm g{Y, (const bf16*)(ws + WS_WOUT), M, DM, DM}; pg8::StaticOrder S; S.init(M, DM, G, bx); pg8::EpiResid E{args.in[0], H, XN, part1, DM};
        pg8::gemm_phase<pg8::EpiResid, pg8::StaticOrder, true, true>(lds, g, S, E);
    }
    SEAM(3);
    if (IN(4)) {
        pg8::Gemm g{XN, (const bf16*)(ws + WS_WGU), M, 2 * FF, DM}; pg8::StaticOrder S; S.init(M, 2 * FF, G, bx); pg8::EpiSwiGLU E{ACT, FF, part1};
        pg8::gemm_phase<pg8::EpiSwiGLU, pg8::StaticOrder, true, true>(lds, g, S, E);
    }
    SEAM(4);
    if (IN(5)) {
        pg8::Gemm g{ACT, (const bf16*)(ws + WS_WDN), M, DM, FF}; pg8::StaticOrder S; S.init(M, DM, G, bx); pg8::EpiResid E{H, H, XN, part2, DM};
        pg8::gemm_phase<pg8::EpiResid, pg8::StaticOrder, true, true>(lds, g, S, E);
    }
    SEAM(5);
    if (IN(6)) {
        pg8::Gemm g{XN, (const bf16*)(ws + WS_WPG), M, DM, DM}; pg8::StaticOrder S; S.init(M, DM, G, bx); pg8::EpiPle E{H, PP, part2, part3, DM};
        pg8::gemm_phase<pg8::EpiPle, pg8::StaticOrder, true, true>(lds, g, S, E);
    }
    SEAM(6);
    if (IN(7)) {
        const float* gf = args.in[14];
        f32x4 gv[4];
#pragma unroll
        for (int j = 0; j < 4; ++j) gv[j] = ((const f32x4*)gf)[lane + 64 * j];
        for (int m = vcu * NWAVES + wave; m < M; m += G * NWAVES) {
            float s = lane < 16 ? part3[(size_t)m * 16 + lane] : 0.f; s = wave_sum(s);
            const float rs = __builtin_amdgcn_rsqf(s * (1.0f / DM) + 1e-6f);
            f32x4* hr = (f32x4*)(H + (size_t)m * DM) + lane;
#pragma unroll
            for (int j = 0; j < 4; ++j) hr[64 * j] = hr[64 * j] * rs * gv[j];
        }
    }
#undef IN
#undef SEAM
}

extern "C" void kernel_launch(void* const* d_in, const int* in_sizes, int n_in, void* d_out, int out_size, void* d_ws, size_t ws_size, hipStream_t stream) {
    static int grid = 0;
    if (grid == 0) {
        if (n_in != 15 || in_sizes[0] != M * DM || out_size != M * DM || ws_size < WS_END) { fprintf(stderr, "kernel_launch: unexpected problem shape (n_in %d, in0 %d, out %d, ws %zu); nothing launched\n", n_in, n_in > 0 ? in_sizes[0] : -1, out_size, ws_size); grid = -1; return; }
        int dev = 0, cus = 0, per_cu = 0;
        if (hipGetDevice(&dev) != hipSuccess || hipDeviceGetAttribute(&cus, hipDeviceAttributeMultiprocessorCount, dev) != hipSuccess) { grid = -1; return; }
        if (hipFuncSetAttribute((const void*)mk_fwd, hipFuncAttributeMaxDynamicSharedMemorySize, LDS_BYTES) != hipSuccess) { fprintf(stderr, "kernel_launch: hipFuncSetAttribute failed\n"); grid = -1; return; }
        if (hipOccupancyMaxActiveBlocksPerMultiprocessor(&per_cu, (const void*)mk_fwd, NTHR, LDS_BYTES) != hipSuccess || per_cu < 1) { fprintf(stderr, "kernel_launch: occupancy query says %d blocks per CU; nothing launched\n", per_cu); grid = -1; return; }
        grid = cus;
    }
    if (grid < 0) return;
    Args a{};
    for (int i = 0; i < 15; ++i) a.in[i] = (const float*)d_in[i];
    a.out = (float*)d_out; a.ws = (unsigned char*)d_ws;
#if MK_N_LAUNCHES == 1
    a.ph_lo = 0; a.ph_hi = N_PHASES;
    void* kargs[] = {&a};
    const hipError_t e = hipLaunchCooperativeKernel((void*)mk_fwd, dim3(grid), dim3(NTHR), kargs, LDS_BYTES, stream);
    if (e != hipSuccess) fprintf(stderr, "kernel_launch: cooperative launch failed: %s (grid %d)\n", hipGetErrorString(e), grid);
#else
    for (int ph = 0; ph < N_PHASES; ++ph) { a.ph_lo = ph; a.ph_hi = ph + 1; hipLaunchKernelGGL(mk_fwd, dim3(grid), dim3(NTHR), LDS_BYTES, stream, a); }
#endif
}
```
